# Optimizing an MI355X kernel written in HIP

```python
import jax, jax.numpy as jnp
from jax import lax
import numpy as np

D_MODEL = 4096
BATCH = 2
SEQ = 4096
DEPTH = 2
DEC_BATCH = 8
DEC_SEQ = 32
PAST_LEN = 4096

CHUNK = 64
MIX_WIDTH = D_MODEL
W_A = MIX_WIDTH // 2
W_B = MIX_WIDTH // 4
W_C = MIX_WIDTH // 4
DV_A = 128
H_A = W_A // DV_A
DK_A = DV_A // 2
QK_A = H_A * DK_A
GLA_RANK = 16
GLA_TAU = 16.0
GMLP_CHUNK = 128
H_B = 8
DH_B = W_B // H_B
H_C = 8
DH_C = W_C // H_C
CONV_W = 4
LRU_C = 8.0
D_FF = 4 * D_MODEL
EPS = 1e-6
PROJ_SIZES = (QK_A, QK_A, W_A, W_A, GLA_RANK, W_B, W_B, W_C, W_C)
PROJ_WIDTH = sum(PROJ_SIZES)

kernel_name = 'hybrid_stream_gla_gmlp_rglru'


def rmsnorm(x, g):
    xf = x.astype(jnp.float32)
    y = xf * lax.rsqrt(jnp.mean(jnp.square(xf), axis=-1, keepdims=True) + EPS)
    return (y * g.astype(jnp.float32)).astype(x.dtype)


def gla_chunked(q, k, v, log_a, s0):
    bsz, t, h, dk = q.shape
    c = min(CHUNK, t)
    n = t // c
    def to_chunks(z):
        return jnp.swapaxes(z.astype(jnp.float32).reshape(bsz, n, c, *z.shape[2:]), 0, 1)
    qs, ks, vs, gs = to_chunks(q), to_chunks(k), to_chunks(v), to_chunks(log_a)
    mask = jnp.tril(jnp.ones((c, c), bool))
    def step(s, inp):
        qc, kc, vc, gc = inp
        b = jnp.cumsum(gc, axis=1)
        b_end = b[:, -1]
        q_t = qc * jnp.exp(b)
        k_t = kc * jnp.exp(-b)
        k_e = kc * jnp.exp(b_end[:, None] - b)
        att = jnp.where(mask, jnp.einsum('bihk,bjhk->bhij', q_t, k_t), 0.0)
        o = jnp.einsum('bhij,bjhv->bihv', att, vc) + jnp.einsum('bihk,bhkv->bihv', q_t, s)
        s = jnp.exp(b_end)[..., None] * s + jnp.einsum('bjhk,bjhv->bhkv', k_e, vc)
        return s, o
    s, o = lax.scan(step, s0.astype(jnp.float32), (qs, ks, vs, gs))
    return jnp.swapaxes(o, 0, 1).reshape(bsz, t, h, -1), s


def spatial_gate(u, v, w_sp, b_sp):
    bsz, t, _ = v.shape
    c = min(GMLP_CHUNK, t)
    n = t // c
    vh = v.reshape(bsz, n, c, H_B, DH_B)
    w = jnp.where(jnp.tril(jnp.ones((c, c), bool)), w_sp[:, :c, :c], 0.0)
    mixed = jnp.einsum('hij,bnjhd->bnihd', w, vh) + b_sp[:, :c].T[None, None, :, :, None]
    return u * mixed.reshape(bsz, t, W_B).astype(u.dtype)


def causal_conv(x, buf, w, b):
    t = x.shape[1]
    xp = jnp.concatenate([buf.astype(x.dtype), x], axis=1)
    y = b + xp[:, 0:t] * w[0]
    for j in range(1, CONV_W):
        y = y + xp[:, j:j + t] * w[j]
    return y, xp[:, -(CONV_W - 1):]


def rg_lru(xc, h0, w_r, b_r, w_i, b_i, lam):
    f32 = jnp.float32
    xf = xc.astype(f32)
    bsz, t, _ = xf.shape
    xh = xf.reshape(bsz, t, H_C, DH_C)
    r = jax.nn.sigmoid(jnp.einsum('bthi,hij->bthj', xh, w_r.astype(f32)).reshape(bsz, t, W_C) + b_r.astype(f32))
    ig = jax.nn.sigmoid(jnp.einsum('bthi,hij->bthj', xh, w_i.astype(f32)).reshape(bsz, t, W_C) + b_i.astype(f32))
    log_a = -LRU_C * r * jax.nn.softplus(-lam.astype(f32))
    a = jnp.exp(log_a)
    bt = jnp.sqrt(-jnp.expm1(2.0 * log_a)) * (ig * xf)
    bt = bt.at[:, 0].add(a[:, 0] * h0.astype(f32))
    def combine(e1, e2):
        a1, b1 = e1
        a2, b2 = e2
        return a1 * a2, a2 * b1 + b2
    _, h = lax.associative_scan(combine, (a, bt), axis=1)
    return h, h[:, -1]


def trunk_layer(x, s_gla, s_conv, s_lru, ln1, w_in, w_alpha2, b_alpha, g_onorm, w_spatial, b_spatial,
                conv_w, conv_b, w_rgate, b_rgate, w_igate, b_igate, lru_lambda, w_out, ln2, w_up, w_down):
    bsz, t, _ = x.shape
    hproj = rmsnorm(x, ln1) @ w_in
    splits = np.cumsum(PROJ_SIZES)[:-1].tolist()
    q, k, v, g, a_lr, u_b, v_b, x_c, gate_c = jnp.split(hproj, splits, axis=-1)
    q = q.reshape(bsz, t, H_A, DK_A) * (DK_A ** -0.5)
    k = k.reshape(bsz, t, H_A, DK_A)
    v = v.reshape(bsz, t, H_A, DV_A)
    log_alpha = jax.nn.log_sigmoid((a_lr @ w_alpha2 + b_alpha).astype(jnp.float32)) / GLA_TAU
    o_a, s_gla_new = gla_chunked(q, k, v, log_alpha.reshape(bsz, t, H_A, DK_A), s_gla)
    o_a = rmsnorm(o_a, g_onorm).reshape(bsz, t, W_A).astype(x.dtype) * jax.nn.silu(g)
    u_b = jax.nn.gelu(u_b)
    v_b = jax.nn.gelu(v_b)
    o_b = spatial_gate(u_b, v_b, w_spatial, b_spatial)
    xcv, s_conv_new = causal_conv(x_c, s_conv, conv_w, conv_b)
    hseq, s_lru_new = rg_lru(xcv, s_lru, w_rgate, b_rgate, w_igate, b_igate, lru_lambda)
    o_c = hseq.astype(x.dtype) * jax.nn.gelu(gate_c)
    x = x + jnp.concatenate([o_a, o_b, o_c], axis=-1) @ w_out
    x = x + jnp.square(jax.nn.relu(rmsnorm(x, ln2) @ w_up)) @ w_down
    return x, s_gla_new, s_conv_new, s_lru_new, v_b


def setup_inputs(seed: int = 0) -> dict:
    key = jax.random.key(seed)
    ks = jax.random.split(key, 24)
    f32 = jnp.float32
    nrm = lambda kk, shape: jax.random.normal(kk, shape, f32)
    d = DEPTH
    a0 = jax.random.uniform(ks[18], (d, W_C), f32, 0.9, 0.999)
    a_root = a0 ** (1.0 / LRU_C)
    return {
        'x_prompt': nrm(ks[0], (BATCH, SEQ, D_MODEL)),
        'x_sample': nrm(ks[1], (DEC_BATCH, DEC_SEQ, D_MODEL)),
        'state_gla': 0.5 * nrm(ks[2], (d, DEC_BATCH, H_A, DK_A, DV_A)),
        'state_conv': nrm(ks[3], (d, DEC_BATCH, CONV_W - 1, W_C)),
        'state_lru': 0.5 * nrm(ks[4], (d, DEC_BATCH, W_C)),
        'ln1': 1.0 + 0.02 * nrm(ks[5], (d, D_MODEL)),
        'w_in': nrm(ks[6], (d, D_MODEL, PROJ_WIDTH)) * D_MODEL ** -0.5,
        'w_alpha2': nrm(ks[7], (d, GLA_RANK, QK_A)) * GLA_RANK ** -0.5,
        'b_alpha': 0.1 * nrm(ks[8], (d, QK_A)),
        'g_onorm': 1.0 + 0.02 * nrm(ks[9], (d, DV_A)),
        'w_spatial': nrm(ks[10], (d, H_B, GMLP_CHUNK, GMLP_CHUNK)) * GMLP_CHUNK ** -0.5,
        'b_spatial': 1.0 + 0.02 * nrm(ks[11], (d, H_B, GMLP_CHUNK)),
        'conv_w': nrm(ks[12], (d, CONV_W, W_C)) * CONV_W ** -0.5,
        'conv_b': 0.02 * nrm(ks[13], (d, W_C)),
        'w_rgate': nrm(ks[14], (d, H_C, DH_C, DH_C)) * DH_C ** -0.5,
        'b_rgate': 0.02 * nrm(ks[15], (d, W_C)),
        'w_igate': nrm(ks[16], (d, H_C, DH_C, DH_C)) * DH_C ** -0.5,
        'b_igate': 0.02 * nrm(ks[17], (d, W_C)),
        'lru_lambda': jnp.log(a_root) - jnp.log1p(-a_root),
        'w_out': nrm(ks[19], (d, MIX_WIDTH, D_MODEL)) * MIX_WIDTH ** -0.5,
        'ln2': 1.0 + 0.02 * nrm(ks[20], (d, D_MODEL)),
        'w_up': nrm(ks[21], (d, D_MODEL, D_FF)) * D_MODEL ** -0.5,
        'w_down': nrm(ks[22], (d, D_FF, D_MODEL)) * D_FF ** -0.5,
        'ln_final': 1.0 + 0.02 * nrm(ks[23], (D_MODEL,)),
    }


def reference(x_prompt, x_sample, state_gla, state_conv, state_lru, ln1, w_in, w_alpha2, b_alpha, g_onorm,
              w_spatial, b_spatial, conv_w, conv_b, w_rgate, b_rgate, w_igate, b_igate, lru_lambda, w_out,
              ln2, w_up, w_down, ln_final):
    bp = x_prompt.shape[0]
    zero_gla = jnp.zeros((bp, H_A, DK_A, DV_A), jnp.float32)
    zero_conv = jnp.zeros((bp, CONV_W - 1, W_C), x_prompt.dtype)
    zero_lru = jnp.zeros((bp, W_C), jnp.float32)
    xp, xs = x_prompt, x_sample
    gla_p, conv_p, lru_p, gla_s, conv_s, lru_s, v_s = [], [], [], [], [], [], []
    for l in range(DEPTH):
        w = (ln1[l], w_in[l], w_alpha2[l], b_alpha[l], g_onorm[l], w_spatial[l], b_spatial[l], conv_w[l],
             conv_b[l], w_rgate[l], b_rgate[l], w_igate[l], b_igate[l], lru_lambda[l], w_out[l], ln2[l],
             w_up[l], w_down[l])
        xp, g1, c1, h1, _ = trunk_layer(xp, zero_gla, zero_conv, zero_lru, *w)
        xs, g2, c2, h2, v2 = trunk_layer(xs, state_gla[l], state_conv[l], state_lru[l], *w)
        gla_p.append(g1); conv_p.append(c1); lru_p.append(h1)
        gla_s.append(g2); conv_s.append(c2); lru_s.append(h2); v_s.append(v2)
    y_prompt = rmsnorm(xp, ln_final)
    y_sample = rmsnorm(xs, ln_final)
    return (y_prompt, y_sample, jnp.stack(gla_p), jnp.stack(conv_p), jnp.stack(lru_p),
            jnp.stack(gla_s), jnp.stack(conv_s), jnp.stack(lru_s), jnp.stack(v_s))
```

```cpp
#include <hip/hip_runtime.h>
#include <cstdio>
#include <cstdint>
namespace pg8 {
#define PG8_LAS __attribute__((address_space(3)))
typedef unsigned short bf16_t;
typedef short bf16x8 __attribute__((ext_vector_type(8)));
typedef float f32x4 __attribute__((ext_vector_type(4)));
typedef unsigned u32x4 __attribute__((ext_vector_type(4)));
constexpr int BM = 256, BK = 64, HALF = 128, HTB = HALF * BK * 2  , STAGE_BYTES = 8 * HTB, NXCD = 8, WGM = 8;

__host__ __device__ __forceinline__ int lds_byte(int r, int c) { const int st = (r >> 4) * 2 + (c >> 5), rr = r & 15, cc = c & 31, ob = rr * 64 + cc * 2; return st * 1024 + (ob ^ (((ob >> 9) & 1) << 5)); }
__host__ __device__ __forceinline__ void stage_rc(int b, int& R, int& C) { const int st = b / 1024, sb = b % 1024, swz = sb ^ (((sb >> 9) & 1) << 5); R = (st >> 1) * 16 + swz / 64; C = (st & 1) * 32 + (swz % 64) / 2; }
__host__ __device__ __forceinline__ int perm32(int rho) { const int n = rho >> 4, i = rho & 15; return 8 * (i >> 2) + 4 * n + (i & 3); }

struct Unit { int pm, pn; };
struct Gemm { const bf16_t* A; const bf16_t* Bt; int M, N, K; };

struct StaticOrder {
    int nM, nN, nwg, G, c;
    __host__ __device__ void init(int M, int N, int G_, int c_) { nM = M / BM; nN = N / BM; nwg = nM * nN; G = G_; c = c_; }
    __host__ __device__ bool next(int i, Unit& u) const {
        const long L = (long)i * G + c; if (L >= nwg) return false;
        int wgid = (int)L; { const int q = nwg / NXCD, r = nwg % NXCD, xcd = wgid % NXCD, off = wgid / NXCD; wgid = (xcd < r ? xcd * (q + 1) : r * (q + 1) + (xcd - r) * q) + off; }
        const int nig = WGM * nN, gid = wgid / nig, fm = gid * WGM, gsz = (nM - fm) < WGM ? (nM - fm) : WGM;
        u.pm = fm + ((wgid % nig) % gsz); u.pn = (wgid % nig) / gsz; return true;
    }
    __device__ __forceinline__ void a_ready(const Unit&) const {}
    __device__ __forceinline__ void done(const Unit&) const {}
};

__device__ __forceinline__ unsigned cvt_pk_bf16(float lo, float hi) { unsigned r; asm volatile("v_cvt_pk_bf16_f32 %0, %1, %2" : "=v"(r) : "v"(lo), "v"(hi)); return r; }
typedef float f32x2 __attribute__((ext_vector_type(2)));
__device__ __forceinline__ f32x2 gelu_pk(f32x2 v) {
    const f32x2 av = __builtin_elementwise_abs(v), d = av * 0.2316418882f + 1.0f;
    f32x2 t; t.x = __builtin_amdgcn_rcpf(d.x); t.y = __builtin_amdgcn_rcpf(d.y);
    f32x2 q = t * 0.5307027145f + (-0.7265760135f); q = q * t + 0.7107068705f; q = q * t + (-0.142248368f); q = q * t + 0.127414796f; q = q * t;
    const f32x2 s = (v * v) * (-0.72134752044f);
    f32x2 e; e.x = __builtin_amdgcn_exp2f(s.x); e.y = __builtin_amdgcn_exp2f(s.y);
    const f32x2 m = v * (q * e), r = v - m;
    f32x2 o; o.x = v.x < 0.f ? m.x : r.x; o.y = v.y < 0.f ? m.y : r.y; return o;
}

template <int ACT  > struct EpiBf16 {
    static constexpr bool PERM = true, AFTER_DRAIN = false; static_assert(ACT == 0 || ACT == 1, "EpiBf16: ACT is 0 (none) or 1 (gelu_pk)");
    bf16_t* O; int ldc; const float* bias; int split_cols; size_t split_stride; float scale0;
    __device__ __forceinline__ void operator()(const f32x4 (&acc)[2][2][4][2], const Unit& u, int wr, int wc, int fr, int fq) const {
        const int row0 = u.pm * BM + wr * 64 + fr; int colt = u.pn * BM; bf16_t* base = O;
        float sc = 1.f; if (split_cols) { const int t = colt / split_cols; base += (size_t)t * split_stride; colt -= t * split_cols; if (t == 0) sc = scale0; }
        const int col0 = colt + wc * 32 + 8 * fq, bcol0 = u.pn * BM + wc * 32 + 8 * fq;
        f32x4 bv[2][2];
#pragma unroll
        for (int bj = 0; bj < 2; ++bj)
#pragma unroll
            for (int n = 0; n < 2; ++n) bv[bj][n] = bias ? *(const f32x4*)(bias + bcol0 + bj * HALF + 4 * n) : (f32x4){0.f, 0.f, 0.f, 0.f};
#pragma unroll
        for (int ai = 0; ai < 2; ++ai)
#pragma unroll
            for (int m = 0; m < 4; ++m) { bf16_t* rowp = base + (size_t)(row0 + ai * HALF + m * 16) * ldc + col0;
#pragma unroll
                for (int bj = 0; bj < 2; ++bj) { f32x4 v0 = acc[ai][bj][m][0] + bv[bj][0], v1 = acc[ai][bj][m][1] + bv[bj][1];
                    if (ACT == 1) { f32x2 a = gelu_pk((f32x2){v0[0], v0[1]}), b = gelu_pk((f32x2){v0[2], v0[3]}), c = gelu_pk((f32x2){v1[0], v1[1]}), d = gelu_pk((f32x2){v1[2], v1[3]});
                        v0 = (f32x4){a.x, a.y, b.x, b.y}; v1 = (f32x4){c.x, c.y, d.x, d.y}; }
                    v0 = v0 * sc; v1 = v1 * sc; u32x4 w; w.x = cvt_pk_bf16(v0[0], v0[1]); w.y = cvt_pk_bf16(v0[2], v0[3]); w.z = cvt_pk_bf16(v1[0], v1[1]); w.w = cvt_pk_bf16(v1[2], v1[3]);
                    *(u32x4*)(rowp + bj * HALF) = w; } }
    }
};

struct EpiResid {
    static constexpr bool PERM = false, AFTER_DRAIN = false;
    const float* basep; const float* bases; float* out; int ldc;
    __device__ __forceinline__ void operator()(const f32x4 (&acc)[2][2][4][2], const Unit& u, int wr, int wc, int fr, int fq) const {
        const int rloc = wr * 64 + fr, col0 = u.pn * BM + wc * 32 + 4 * fq;
        const float* bt = (u.pm < 32) ? basep + (size_t)u.pm * BM * ldc : bases;
        float* ot = out + (size_t)u.pm * BM * ldc;
#pragma unroll
        for (int ai = 0; ai < 2; ++ai)
#pragma unroll
            for (int m = 0; m < 4; ++m) { const size_t off = (size_t)(rloc + ai * HALF + m * 16) * ldc + col0;
#pragma unroll
                for (int bj = 0; bj < 2; ++bj)
#pragma unroll
                    for (int n = 0; n < 2; ++n) { const f32x4 bs = *(const f32x4*)(bt + off + bj * HALF + n * 16); *(f32x4*)(ot + off + bj * HALF + n * 16) = bs + acc[ai][bj][m][n]; }
                asm volatile("" ::: "memory"); }
    }
};
struct EpiRelu2 {
    static constexpr bool PERM = true, AFTER_DRAIN = false;
    bf16_t* O; int ldc;
    __device__ __forceinline__ void operator()(const f32x4 (&acc)[2][2][4][2], const Unit& u, int wr, int wc, int fr, int fq) const {
        const int row0 = u.pm * BM + wr * 64 + fr, col0 = u.pn * BM + wc * 32 + 8 * fq;
#pragma unroll
        for (int ai = 0; ai < 2; ++ai)
#pragma unroll
            for (int m = 0; m < 4; ++m) { bf16_t* rowp = O + (size_t)(row0 + ai * HALF + m * 16) * ldc + col0;
#pragma unroll
                for (int bj = 0; bj < 2; ++bj) { f32x4 v0 = acc[ai][bj][m][0], v1 = acc[ai][bj][m][1];
#pragma unroll
                    for (int j = 0; j < 4; ++j) { const float a = fmaxf(v0[j], 0.f), b = fmaxf(v1[j], 0.f); v0[j] = a * a; v1[j] = b * b; }
                    u32x4 w; w.x = cvt_pk_bf16(v0[0], v0[1]); w.y = cvt_pk_bf16(v0[2], v0[3]); w.z = cvt_pk_bf16(v1[0], v1[1]); w.w = cvt_pk_bf16(v1[2], v1[3]);
                    *(u32x4*)(rowp + bj * HALF) = w; } }
    }
};

template <class Epi, class Sched, bool ALIGN_EPI = false, bool SP2 = false>
__device__ __forceinline__ void gemm_phase(PG8_LAS unsigned char* lds, const Gemm g, const Sched& S, const Epi& E) {
    int tid_l = threadIdx.x; asm volatile("" : "+v"(tid_l));
    const int tid = tid_l, wid = __builtin_amdgcn_readfirstlane(tid >> 6), lane = tid & 63, wr = wid >> 2, wc = wid & 3, fr = lane & 15, fq = lane >> 4;
    const int K = g.K, nt = K / BK;
    unsigned voffA[2], voffB[2];
#pragma unroll
    for (int i = 0; i < 2; ++i) { int R, C; stage_rc(tid * 16 + i * 8192, R, C); const int Rb = Epi::PERM ? ((R & ~31) + perm32(R & 31)) : R;
        voffA[i] = (unsigned)(R * K + C) * 2u; voffB[i] = (unsigned)(Rb * K + C) * 2u; }
    const size_t kstep = (size_t)(BK * 2);
    const size_t hstep = (size_t)HALF * K * 2;
    const size_t tstep = 2 * hstep;
    const unsigned ldsw = (unsigned)wid * 1024u;
    const int aoff = lds_byte(wr * 64 + fr, fq * 8), boff = lds_byte(wc * 32 + fr, fq * 8);
#define PG8_SA(b, h) (((b) * 2 + (h)) * HTB)
#define PG8_SB(b, h) ((4 + (b) * 2 + (h)) * HTB)
#define PG8_STAGE(bufoff, gbase, voff) do { _Pragma("unroll") for (int _i = 0; _i < 2; ++_i) \
        __builtin_amdgcn_global_load_lds((const unsigned*)((const char*)(gbase) + (voff)[_i]), (PG8_LAS unsigned*)(lds + (bufoff) + ldsw + _i * 8192), 16, 0, 0); } while (0)
#define PG8_LDA(dst, b, h) do { _Pragma("unroll") for (int m = 0; m < 4; ++m) _Pragma("unroll") for (int k = 0; k < 2; ++k) dst[m][k] = *(const PG8_LAS bf16x8*)(lds + PG8_SA(b, h) + aoff + m * 2048 + k * 1024); } while (0)
#define PG8_LDB(dst, b, h) do { _Pragma("unroll") for (int n = 0; n < 2; ++n) _Pragma("unroll") for (int k = 0; k < 2; ++k) dst[n][k] = *(const PG8_LAS bf16x8*)(lds + PG8_SB(b, h) + boff + n * 2048 + k * 1024); } while (0)
#define PG8_MMA(ai, bj, At, Bt) do { __builtin_amdgcn_s_setprio(1); _Pragma("unroll") for (int m = 0; m < 4; ++m) _Pragma("unroll") for (int n = 0; n < 2; ++n) _Pragma("unroll") for (int k = 0; k < 2; ++k) \
        acc[ai][bj][m][n] = __builtin_amdgcn_mfma_f32_16x16x32_bf16(Bt[n][k], At[m][k], acc[ai][bj][m][n], 0, 0, 0); __builtin_amdgcn_s_setprio(0); } while (0)
#define PG8_WAIT_V(n) asm volatile("s_waitcnt vmcnt(" #n ")" ::: "memory")
#define PG8_WAIT_L(n) asm volatile("s_waitcnt lgkmcnt(" #n ")" ::: "memory")
#define PG8_BAR __builtin_amdgcn_s_barrier()
#define PG8_SCHED __builtin_amdgcn_sched_barrier(0)
    Unit cur, nxt; int ui = 0;
    if (!S.next(0, cur)) return;
    f32x4 acc[2][2][4][2];
#pragma unroll
    for (int a = 0; a < 2; ++a)
#pragma unroll
        for (int b = 0; b < 2; ++b)
#pragma unroll
            for (int m = 0; m < 4; ++m)
#pragma unroll
                for (int n = 0; n < 2; ++n) acc[a][b][m][n] = (f32x4){0.f, 0.f, 0.f, 0.f};
    bf16x8 At[4][2], B0[2][2], B1[2][2];
    const char* cA = (const char*)g.A + (size_t)cur.pm * tstep; const char* cB = (const char*)g.Bt + (size_t)cur.pn * tstep;
    S.a_ready(cur);
    if constexpr (SP2) {
        PG8_STAGE(PG8_SB(0, 0), cB, voffB); PG8_STAGE(PG8_SB(0, 1), cB + hstep, voffB); PG8_STAGE(PG8_SA(0, 0), cA, voffA); PG8_STAGE(PG8_SA(0, 1), cA + hstep, voffA);
        if (wr == 1) PG8_BAR;
        PG8_WAIT_V(2); PG8_BAR;
        PG8_STAGE(PG8_SB(1, 0), cB + kstep, voffB); PG8_STAGE(PG8_SA(1, 0), cA + kstep, voffA); PG8_STAGE(PG8_SB(1, 1), cB + hstep + kstep, voffB);
        PG8_WAIT_V(6); PG8_BAR;
    } else {
        PG8_STAGE(PG8_SB(0, 0), cB, voffB); PG8_STAGE(PG8_SA(0, 0), cA, voffA); PG8_STAGE(PG8_SB(0, 1), cB + hstep, voffB); PG8_STAGE(PG8_SA(0, 1), cA + hstep, voffA);
        if (wr == 1) PG8_BAR;
        PG8_WAIT_V(4); PG8_BAR;
        PG8_STAGE(PG8_SB(1, 0), cB + kstep, voffB); PG8_STAGE(PG8_SA(1, 0), cA + kstep, voffA); PG8_STAGE(PG8_SB(1, 1), cB + hstep + kstep, voffB);
        PG8_WAIT_V(6); PG8_BAR;
    }
    for (;;) {
        const bool has_next = S.next(ui + 1, nxt);
        const char* nA = has_next ? (const char*)g.A + (size_t)nxt.pm * tstep : cA; const char* nB = has_next ? (const char*)g.Bt + (size_t)nxt.pn * tstep : cB;
        for (int t = 0; t < nt; t += 2) {
            const bool last = (t == nt - 2);
            const char* a1 = cA + (size_t)(t + 1) * kstep;
            const char* a2 = last ? nA : cA + (size_t)(t + 2) * kstep; const char* b2 = last ? nB : cB + (size_t)(t + 2) * kstep;
            const char* a3 = a2 + kstep; const char* b3 = b2 + kstep;
            if (last && has_next) S.a_ready(nxt);
            if constexpr (SP2) {
            PG8_LDB(B0, 0, 0); PG8_LDB(B1, 0, 1); PG8_SCHED; PG8_LDA(At, 0, 0); PG8_STAGE(PG8_SA(1, 1), a1 + hstep, voffA);
            PG8_WAIT_V(8); PG8_WAIT_L(0); PG8_BAR; PG8_MMA(0, 0, At, B0); PG8_MMA(0, 1, At, B1); PG8_BAR; PG8_SCHED;
            PG8_LDA(At, 0, 1); PG8_STAGE(PG8_SB(0, 0), b2, voffB); PG8_STAGE(PG8_SB(0, 1), b2 + hstep, voffB); PG8_STAGE(PG8_SA(0, 0), a2, voffA);
            PG8_WAIT_V(8); PG8_WAIT_L(0); PG8_BAR; PG8_MMA(1, 0, At, B0); PG8_MMA(1, 1, At, B1); PG8_BAR; PG8_SCHED;
            PG8_LDB(B0, 1, 0); PG8_LDB(B1, 1, 1); PG8_SCHED; PG8_LDA(At, 1, 0); PG8_STAGE(PG8_SA(0, 1), a2 + hstep, voffA);
            PG8_WAIT_V(8); PG8_WAIT_L(0); PG8_BAR; PG8_MMA(0, 0, At, B0); PG8_MMA(0, 1, At, B1); PG8_BAR; PG8_SCHED;
            PG8_LDA(At, 1, 1); PG8_STAGE(PG8_SB(1, 0), b3, voffB); PG8_STAGE(PG8_SB(1, 1), b3 + hstep, voffB); PG8_STAGE(PG8_SA(1, 0), a3, voffA);
            PG8_WAIT_V(8); PG8_WAIT_L(0); PG8_BAR; PG8_MMA(1, 0, At, B0); PG8_MMA(1, 1, At, B1); PG8_BAR; PG8_SCHED;
            } else {
            PG8_LDB(B0, 0, 0); PG8_SCHED; PG8_LDA(At, 0, 0); PG8_STAGE(PG8_SA(1, 1), a1 + hstep, voffA);
            PG8_WAIT_L(8); PG8_BAR; PG8_WAIT_L(0); PG8_MMA(0, 0, At, B0); PG8_BAR; PG8_SCHED;
            PG8_LDB(B1, 0, 1); PG8_STAGE(PG8_SB(0, 0), b2, voffB);
            PG8_BAR; PG8_WAIT_L(0); PG8_MMA(0, 1, At, B1); PG8_BAR;
            PG8_LDA(At, 0, 1); PG8_STAGE(PG8_SA(0, 0), a2, voffA);
            PG8_BAR; PG8_WAIT_L(0); PG8_MMA(1, 0, At, B0); PG8_BAR; PG8_SCHED;
            PG8_STAGE(PG8_SB(0, 1), b2 + hstep, voffB);
            PG8_WAIT_V(6); PG8_BAR; PG8_MMA(1, 1, At, B1); PG8_BAR;
            PG8_LDB(B0, 1, 0); PG8_SCHED; PG8_LDA(At, 1, 0); PG8_STAGE(PG8_SA(0, 1), a2 + hstep, voffA);
            PG8_WAIT_L(8); PG8_BAR; PG8_WAIT_L(0); PG8_MMA(0, 0, At, B0); PG8_BAR; PG8_SCHED;
            PG8_LDB(B1, 1, 1); PG8_STAGE(PG8_SB(1, 0), b3, voffB);
            PG8_BAR; PG8_WAIT_L(0); PG8_MMA(0, 1, At, B1); PG8_BAR;
            PG8_LDA(At, 1, 1); PG8_STAGE(PG8_SA(1, 0), a3, voffA);
            PG8_BAR; PG8_WAIT_L(0); PG8_MMA(1, 0, At, B0); PG8_BAR; PG8_SCHED;
            PG8_STAGE(PG8_SB(1, 1), b3 + hstep, voffB);
            PG8_WAIT_V(6); PG8_BAR; PG8_MMA(1, 1, At, B1); PG8_BAR;
            }
        }
        if constexpr (ALIGN_EPI) { if (wr == 0) PG8_BAR; }
        if constexpr (!Epi::AFTER_DRAIN) { E(acc, cur, wr, wc, fr, fq); S.done(cur); }
        if (!has_next) break;
#pragma unroll
        for (int a = 0; a < 2; ++a)
#pragma unroll
            for (int b = 0; b < 2; ++b)
#pragma unroll
                for (int m = 0; m < 4; ++m)
#pragma unroll
                    for (int n = 0; n < 2; ++n) acc[a][b][m][n] = (f32x4){0.f, 0.f, 0.f, 0.f};
        cur = nxt; cA = nA; cB = nB; ++ui;
        if constexpr (ALIGN_EPI) { if (wr == 1) PG8_BAR; }
    }
    PG8_WAIT_V(0);
    if constexpr (!ALIGN_EPI) { if (wr == 0) PG8_BAR; }
    PG8_BAR;
    if constexpr (Epi::AFTER_DRAIN) { E.fused(acc, cur, wr, wc, fr, fq, lds, wid, lane); S.done(cur); }
#undef PG8_SA
#undef PG8_SB
#undef PG8_STAGE
#undef PG8_LDA
#undef PG8_LDB
#undef PG8_MMA
#undef PG8_WAIT_V
#undef PG8_WAIT_L
#undef PG8_BAR
#undef PG8_SCHED
}
}
#define XB_TMO      128
#define XB_XCNT(j)  (256  + 64 * (j))
#define XB_XSUB(j)  (1280 + 64 * (j))
#define XB_XGEN(j)  (2304 + 64 * (j))
#define XB_TOP      3328
#define XB_TOPGEN   3392
#define XCD_BAR_WORDS 3456
#define XB_SPIN_CAP (1u << 18)
#define LAS __attribute__((address_space(3)))

__device__ __forceinline__ unsigned xb_ld(unsigned* p)              { return __hip_atomic_load(p, __ATOMIC_RELAXED, __HIP_MEMORY_SCOPE_AGENT); }
__device__ __forceinline__ unsigned xb_add(unsigned* p, unsigned v) { return __hip_atomic_fetch_add(p, v, __ATOMIC_RELAXED, __HIP_MEMORY_SCOPE_AGENT); }
__device__ __forceinline__ unsigned xb_xcc_id() { return (unsigned)__builtin_amdgcn_s_getreg((3 << 11) | 20) & 0xFu; }
#define XB_SPIN(cond, bar) do { unsigned _sp = 0; while (cond) { __builtin_amdgcn_s_sleep(1); \
    if ((++_sp & 255u) == 0u) { if (xb_ld(&(bar)[XB_TMO])) break; if (_sp > XB_SPIN_CAP) { atomicAdd(&(bar)[XB_TMO], 1u); break; } } } } while (0)

struct XcdBarrier {
    unsigned* bar; unsigned x;
    volatile LAS unsigned* st;
};

__device__ __forceinline__ XcdBarrier xcd_barrier_post(unsigned* bar, volatile LAS unsigned* st) {
    XcdBarrier b; b.bar = bar; b.x = xb_xcc_id(); b.st = st;
    if (threadIdx.x == 0) (void)xb_add(&bar[XB_XCNT(b.x)], 1u);
    return b;
}
__device__ __forceinline__ void xcd_barrier_complete(unsigned* bar, unsigned x, unsigned& nloc, unsigned& nx) {
    const unsigned G = gridDim.x * gridDim.y * gridDim.z;
    unsigned sum, cnt, mine, sp = 0u;
    for (;;) {
        sum = 0u; cnt = 0u; mine = 0u;
#pragma unroll
        for (unsigned j = 0; j < 16; ++j) { const unsigned c = xb_ld(&bar[XB_XCNT(j)]); sum += c; cnt += (c > 0u) ? 1u : 0u; mine = (j == x) ? c : mine; }
        if (sum == G) break;
        __builtin_amdgcn_s_sleep(1);
        if ((++sp & 255u) == 0u) { if (xb_ld(&bar[XB_TMO])) break; if (sp > XB_SPIN_CAP) { atomicAdd(&bar[XB_TMO], 1u); break; } }
    }
    nloc = mine > 0u ? mine : 1u; nx = cnt > 0u ? cnt : 1u;
}

__device__ __forceinline__ void xcd_barrier(const XcdBarrier& b) {
    asm volatile("s_waitcnt vmcnt(0)" ::: "memory");
    __syncthreads();
    if (threadIdx.x == 0) {
        unsigned* bar = b.bar;
        __builtin_amdgcn_s_waitcnt(0);
        unsigned nloc = b.st[0], nx = b.st[1];
        if (nloc == 0u) { xcd_barrier_complete(bar, b.x, nloc, nx); b.st[0] = nloc; b.st[1] = nx; }
        const unsigned old = xb_add(&bar[XB_XSUB(b.x)], 1u);
        const unsigned gen = old / nloc;
        if (old + 1u == (gen + 1u) * nloc) {
            __builtin_amdgcn_fence(__ATOMIC_RELEASE, "agent");
            asm volatile("s_waitcnt vmcnt(0)" ::: "memory");
            const unsigned og = xb_add(&bar[XB_TOP], 1u);
            const unsigned tg = og / nx;
            if (og + 1u == (tg + 1u) * nx) xb_add(&bar[XB_TOPGEN], 1u);
            else XB_SPIN(xb_ld(&bar[XB_TOPGEN]) == tg, bar);
            __builtin_amdgcn_fence(__ATOMIC_ACQUIRE, "agent");
            xb_add(&bar[XB_XGEN(b.x)], 1u);
            asm volatile("s_waitcnt vmcnt(0)" ::: "memory");
        } else {
            XB_SPIN(xb_ld(&bar[XB_XGEN(b.x)]) == gen, bar);
            __builtin_amdgcn_fence(__ATOMIC_ACQUIRE, "agent");
            asm volatile("s_waitcnt vmcnt(0)" ::: "memory");
        }
    }
    __syncthreads();
}
#ifndef PH_PRO
#define PH_PRO 1
#endif
#ifndef PH_N1
#define PH_N1 1
#endif
#ifndef PH_GIN
#define PH_GIN 1
#endif
#ifndef PH_M1
#define PH_M1 1
#endif
#ifndef PH_M2A
#define PH_M2A 1
#endif
#ifndef PH_M2B
#define PH_M2B 1
#endif
#ifndef PH_M2C
#define PH_M2C 1
#endif
#ifndef PH_M3
#define PH_M3 1
#endif
#ifndef PH_GOUT
#define PH_GOUT 1
#endif
#ifndef PH_N2
#define PH_N2 1
#endif
#ifndef PH_GUP
#define PH_GUP 1
#endif
#ifndef PH_GDN
#define PH_GDN 1
#endif
#ifndef PH_NF
#define PH_NF 1
#endif

#define GAS __attribute__((address_space(1)))
typedef unsigned short bf16;
typedef unsigned v4u __attribute__((ext_vector_type(4)));
typedef unsigned v2u __attribute__((ext_vector_type(2)));
typedef float f32x4 __attribute__((ext_vector_type(4)));
typedef float f32x2 __attribute__((ext_vector_type(2)));
typedef short bf16x8 __attribute__((ext_vector_type(8)));
#define LDS_WAIT() asm volatile("s_waitcnt lgkmcnt(0)" ::: "memory")

constexpr int D = 4096, MP = 8192, MS = 256, MT = MP + MS, NPROJ = 10240, NPROJ_SRC = 10256, DFF = 16384;
constexpr int C_Q = 0, C_K = 1024, C_V = 2048, C_G = 4096, C_U = 6144, C_VB = 7168, C_XC = 8192, C_GC = 9216;
constexpr int ALR_SRC_COL = 6144;
constexpr float EPS = 1e-6f;
constexpr size_t O_YP = 0, O_YS = 33554432, O_GLAP = 34603008, O_CONVP = 35127296, O_LRUP = 35139584, O_GLAS = 35143680, O_CONVS = 37240832, O_LRUS = 37289984, O_VS = 37306368, O_END = 37830656;
constexpr size_t MiB = 1u << 20;
constexpr size_t WS_CTL = 0, CTL_ZERO_BYTES = 1 * MiB;
constexpr size_t WS_WIN = 2 * MiB;
constexpr size_t WS_WOUT = 162 * MiB;
constexpr size_t WS_WUP = 226 * MiB;
constexpr size_t WS_WDN = 482 * MiB;
constexpr size_t WS_WA = 738 * MiB;
constexpr size_t WS_WRT = 739 * MiB;
constexpr size_t WS_WIT = 739 * MiB + 512 * 1024;
constexpr size_t WS_WSP = 740 * MiB;
constexpr size_t WS_X = 742 * MiB;
constexpr size_t WS_XN = 874 * MiB;
constexpr size_t WS_HP = 940 * MiB;
constexpr size_t WS_MIX = 1105 * MiB;
constexpr size_t WS_HH = 1171 * MiB;
constexpr size_t WS_LT = 1435 * MiB;
constexpr size_t WS_SPT = 1499 * MiB;
constexpr size_t WS_DEC = 1531 * MiB;
constexpr size_t WS_ALR = 1532 * MiB;
constexpr size_t WS_LA = 1533 * MiB;
constexpr size_t WS_LB = 1533 * MiB + 512 * 1024;
constexpr size_t WS_HIN = 1534 * MiB;
constexpr size_t WS_END = 1535 * MiB;
constexpr int CW_BAR = 4096;
constexpr int RING_BYTES = 131072, LDSCTL_OFF = RING_BYTES, MISC_OFF = LDSCTL_OFF + 320, LDS_BYTES = 147456;
constexpr int L_KET = 0, L_VT = 9216, L_QT = 27648, L_KT = 36864, L_ATT = 46080, L_ST = 55296, L_ALR = 73728, L_TOT = 77824, L_SS = 79872, L_RS = 81920, L_DEC = 82176;
constexpr int L_XC = 0, L_RG = 17408, L_IG = 51200, L_QA = 84992, L_QB = 87040;
constexpr int L_VT2 = 0;

struct Args { const float* in[24]; float* out; unsigned char* ws; };

struct Ptrs {
    const float *x_prompt, *x_sample, *state_gla, *state_conv, *state_lru, *ln1, *w_in, *w_alpha2, *b_alpha, *g_onorm, *w_spatial, *b_spatial, *conv_w, *conv_b, *w_rgate, *b_rgate, *w_igate, *b_igate, *lru_lambda, *w_out, *ln2, *w_up, *w_down, *ln_final;
    float* out;
    bf16 *WIN, *WOUT, *WUP, *WDN, *WA, *WRT, *WIT, *WSP, *XN, *HP, *MIX, *HH, *SPT;
    float *X, *LT, *DEC, *ALR, *LA, *LB, *HIN;
};

__device__ __forceinline__ unsigned f2bf(float f) { unsigned u = __float_as_uint(f); return (u + 0x7fffu + ((u >> 16) & 1u)) >> 16; }
__device__ __forceinline__ unsigned pk2(float lo, float hi) { return f2bf(lo) | (f2bf(hi) << 16); }
__device__ __forceinline__ float bf2f(unsigned short b) { return __uint_as_float(((unsigned)b) << 16); }
__device__ __forceinline__ float wave_sum(float v) {
#pragma unroll
    for (int o = 1; o < 64; o <<= 1) v += __shfl_xor(v, o);
    return v;
}
__device__ __forceinline__ float sigmoid_f(float x) { return __fdividef(1.f, 1.f + __expf(-x)); }
__device__ __forceinline__ float silu_f(float x) { return __fdividef(x, 1.f + __expf(-x)); }
__device__ __forceinline__ float gelu_f(float x) { const float u = 0.7978845608028654f * (x + 0.044715f * x * x * x); return __fdividef(x, 1.f + __expf(-2.f * u)); }
__device__ __forceinline__ float logsig_f(float z) { return fminf(z, 0.f) - __logf(1.f + __expf(-fabsf(z))); }
__device__ __forceinline__ int fresh_tid() { int t = threadIdx.x; asm volatile("" : "+v"(t)); return t; }
__device__ __forceinline__ f32x4 mfma16(bf16x8 a, bf16x8 b, f32x4 c) { return __builtin_amdgcn_mfma_f32_16x16x32_bf16(a, b, c, 0, 0, 0); }

__device__ __forceinline__ void tr_item(const float* W, int ldw, int k0, int n0src, bf16* WT, int Kd, int drow0, LAS float* scr, int lane) {
#pragma unroll 8
    for (int i = 0; i < 32; ++i) { const int kk = 2 * i + (lane >> 5); scr[kk * 33 + (lane & 31)] = W[(size_t)(k0 + kk) * ldw + n0src + (lane & 31)]; }
    LDS_WAIT(); asm volatile("" ::: "memory");
    const int c = lane & 7;
#pragma unroll
    for (int j = 0; j < 4; ++j) { const int n = (lane >> 3) + 8 * j; const LAS float* s = scr + (8 * c) * 33 + n;
        v4u o; o.x = pk2(s[0 * 33], s[1 * 33]); o.y = pk2(s[2 * 33], s[3 * 33]); o.z = pk2(s[4 * 33], s[5 * 33]); o.w = pk2(s[6 * 33], s[7 * 33]);
        *(v4u*)(WT + (size_t)(drow0 + n) * Kd + k0 + 8 * c) = o; }
    LDS_WAIT(); asm volatile("" ::: "memory");
}
__device__ __forceinline__ void prologue(LAS unsigned char* lds, const Ptrs& P, int G) {
    const int tid = fresh_tid(), lane = tid & 63, wave = __builtin_amdgcn_readfirstlane(tid >> 6);
    LAS float* scr = (LAS float*)(lds + wave * 16384);
    const int gw = (int)blockIdx.x * 8 + wave, NGW = G * 8;
    constexpr int I_IN = 64 * 320, I_OUT = 64 * 128, I_UP = 64 * 512, I_DN = 256 * 128, I_L = I_IN + I_OUT + I_UP + I_DN;
    for (int it = gw; it < 2 * I_L; it += NGW) {
        const int l = it / I_L; int r = it - l * I_L;
        if (r < I_IN) { const int kb = r / 320, nb = r % 320, n0d = 32 * nb, n0s = n0d < ALR_SRC_COL ? n0d : n0d + 16;
            tr_item(P.w_in + (size_t)l * D * NPROJ_SRC, NPROJ_SRC, 64 * kb, n0s, P.WIN + (size_t)l * NPROJ * D, D, n0d, scr, lane); continue; }
        r -= I_IN;
        if (r < I_OUT) { const int kb = r / 128, nb = r % 128; tr_item(P.w_out + (size_t)l * D * D, D, 64 * kb, 32 * nb, P.WOUT + (size_t)l * D * D, D, 32 * nb, scr, lane); continue; }
        r -= I_OUT;
        if (r < I_UP) { const int kb = r / 512, nb = r % 512; tr_item(P.w_up + (size_t)l * D * DFF, DFF, 64 * kb, 32 * nb, P.WUP + (size_t)l * DFF * D, D, 32 * nb, scr, lane); continue; }
        r -= I_UP;
        { const int kb = r / 128, nb = r % 128; tr_item(P.w_down + (size_t)l * DFF * D, D, 64 * kb, 32 * nb, P.WDN + (size_t)l * D * DFF, DFF, 32 * nb, scr, lane); }
    }
    const int gt = (int)blockIdx.x * 512 + tid, NGT = G * 512;
    for (int i = gt; i < 2 * 16 * D; i += NGT) { const int k = i & (D - 1), r = (i >> 12) & 15, l = i >> 16;
        P.WA[i] = (bf16)f2bf(P.w_in[((size_t)l * D + k) * NPROJ_SRC + ALR_SRC_COL + r]); }
    for (int i = gt; i < 2 * 8 * 128 * 128; i += NGT) { const int ii = i & 127, j = (i >> 7) & 127, lh = i >> 14;
        P.WRT[i] = (bf16)f2bf(P.w_rgate[((size_t)lh * 128 + ii) * 128 + j]); P.WIT[i] = (bf16)f2bf(P.w_igate[((size_t)lh * 128 + ii) * 128 + j]);
        const int jj = i & 127, i2 = (i >> 7) & 127;
        P.WSP[i] = (bf16)(jj <= i2 ? f2bf(P.w_spatial[i]) : 0u); }
}

template <int MODE>
__device__ __forceinline__ void norm_phase(LAS unsigned char* lds, const float* xa, const float* xb, const float* gain, bf16* XN, const bf16* WaT, float* ALR, float* ya, float* yb, int G) {
    const int tid = fresh_tid(), lane = tid & 63, wave = __builtin_amdgcn_readfirstlane(tid >> 6);
    if (MODE == 1) {
        for (int p = tid; p < 8192; p += 512) ((LAS v4u*)lds)[p] = ((const v4u*)WaT)[p];
        __syncthreads();
    }
    for (int m = wave * G + (int)blockIdx.x; m < MT; m += 8 * G) {
        const float* xr = (m < MP) ? xa + (size_t)m * D : xb + (size_t)(m - MP) * D;
        f32x4 v[16]; float s = 0.f;
#pragma unroll
        for (int j = 0; j < 16; ++j) { v[j] = ((const f32x4*)xr)[lane + 64 * j]; s += (v[j].x * v[j].x + v[j].y * v[j].y) + (v[j].z * v[j].z + v[j].w * v[j].w); }
        s = wave_sum(s);
        const float rstd = rsqrtf(s * (1.f / D) + EPS);
#pragma unroll
        for (int j = 0; j < 16; ++j) { const f32x4 g = ((const f32x4*)gain)[lane + 64 * j]; v[j] = v[j] * rstd * g; }
        if (MODE == 2) {
            float* yr = (m < MP) ? ya + (size_t)m * D : yb + (size_t)(m - MP) * D;
#pragma unroll
            for (int j = 0; j < 16; ++j) ((f32x4*)yr)[lane + 64 * j] = v[j];
        } else {
            unsigned long long* o8 = (unsigned long long*)(XN + (size_t)m * D);
#pragma unroll
            for (int j = 0; j < 16; ++j) o8[lane + 64 * j] = (unsigned long long)pk2(v[j].x, v[j].y) | ((unsigned long long)pk2(v[j].z, v[j].w) << 32);
        }
        if (MODE == 1) {
            float mine = 0.f;
#pragma unroll 1
            for (int r = 0; r < 16; ++r) { float a = 0.f; const LAS unsigned char* wrow = lds + r * 8192 + lane * 8;
#pragma unroll
                for (int j = 0; j < 16; ++j) { const v2u w = *(const LAS v2u*)(wrow + j * 512);
                    a += (v[j].x * __uint_as_float(w.x << 16) + v[j].y * __uint_as_float(w.x & 0xffff0000u)) + (v[j].z * __uint_as_float(w.y << 16) + v[j].w * __uint_as_float(w.y & 0xffff0000u)); }
                const float t = wave_sum(a); mine = (lane == r) ? t : mine; }
            if (lane < 16) ALR[(size_t)m * 16 + lane] = mine;
        }
    }
}

__device__ __forceinline__ void gla_stage_alr(LAS unsigned char* lds, const float* ALR, int row0, int ntok, int tid) {
    LAS float* al = (LAS float*)(lds + L_ALR);
#pragma unroll
    for (int q = 0; q < 2; ++q) { const int idx = tid + 512 * q, t = idx >> 4; al[idx] = (t < ntok) ? ALR[(size_t)(row0 + t) * 16 + (idx & 15)] : 0.f; }
}
__device__ __forceinline__ void gla_gates(LAS unsigned char* lds, const float* w2, const float* ba, int h, int ntok, int kd, int oct, float (&b)[8], float& bend) {
    float w[16];
#pragma unroll
    for (int r = 0; r < 16; ++r) w[r] = w2[r * 1024 + h * 64 + kd];
    const float bb = ba[h * 64 + kd];
    const LAS float* al = (const LAS float*)(lds + L_ALR);
    float run = 0.f;
#pragma unroll
    for (int i = 0; i < 8; ++i) { const int t = 8 * oct + i; float z = bb;
#pragma unroll
        for (int r = 0; r < 16; ++r) z += al[t * 16 + r] * w[r];
        const float la = (t < ntok) ? logsig_f(z) * 0.0625f : 0.f; run += la; b[i] = run; }
    LAS float* tot = (LAS float*)(lds + L_TOT);
    tot[oct * 64 + kd] = run;
    __syncthreads();
    float pre = 0.f, all = 0.f;
#pragma unroll
    for (int o = 0; o < 8; ++o) { const float v = tot[o * 64 + kd]; all += v; pre += (o < oct) ? v : 0.f; }
#pragma unroll
    for (int i = 0; i < 8; ++i) b[i] += pre;
    bend = all;
}
__device__ __forceinline__ void gla_stage_vt(LAS unsigned char* lds, const bf16* HP, int row0, int ntok, int h, int tid) {
    const int vd = tid & 127, tq = tid >> 7;
    const bf16* vp = HP + (size_t)(row0 + 16 * tq) * NPROJ + C_V + h * 128 + vd;
    unsigned short vv[16];
#pragma unroll
    for (int i = 0; i < 16; ++i) vv[i] = (16 * tq + i < ntok) ? vp[(size_t)i * NPROJ] : (unsigned short)0;
#pragma unroll
    for (int q = 0; q < 2; ++q) { v4u o; o.x = vv[8 * q + 0] | ((unsigned)vv[8 * q + 1] << 16); o.y = vv[8 * q + 2] | ((unsigned)vv[8 * q + 3] << 16); o.z = vv[8 * q + 4] | ((unsigned)vv[8 * q + 5] << 16); o.w = vv[8 * q + 6] | ((unsigned)vv[8 * q + 7] << 16);
        *(LAS v4u*)(lds + L_VT + vd * 144 + tq * 32 + q * 16) = o; }
}
#define FRAG(base, row, ks) (*(const LAS bf16x8*)(lds + (base) + (row) * 144 + (32 * (ks) + 8 * fq) * 2))

__device__ __forceinline__ void gla_local_unit(LAS unsigned char* lds, const Ptrs& P, int l, int u) {
    const int tid = fresh_tid(), lane = tid & 63, w = __builtin_amdgcn_readfirstlane(tid >> 6), fr = lane & 15, fq = lane >> 4, kd = tid & 63, oct = w;
    const int b = u >> 10, n = (u >> 4) & 63, h = u & 15, row0 = b * 4096 + n * 64;
    __syncthreads();
    gla_stage_alr(lds, P.ALR, row0, 64, tid);
    gla_stage_vt(lds, P.HP, row0, 64, h, tid);
    __syncthreads();
    float bc[8], bend;
    gla_gates(lds, P.w_alpha2 + (size_t)l * 16 * 1024, P.b_alpha + l * 1024, h, 64, kd, oct, bc, bend);
    { const bf16* kp = P.HP + (size_t)(row0 + 8 * oct) * NPROJ + C_K + h * 64 + kd; float ke[8];
#pragma unroll
      for (int i = 0; i < 8; ++i) ke[i] = bf2f(kp[(size_t)i * NPROJ]) * __expf(bend - bc[i]);
      v4u o; o.x = pk2(ke[0], ke[1]); o.y = pk2(ke[2], ke[3]); o.z = pk2(ke[4], ke[5]); o.w = pk2(ke[6], ke[7]);
      *(LAS v4u*)(lds + L_KET + kd * 144 + oct * 16) = o; }
    if (oct == 0) P.DEC[(size_t)u * 64 + kd] = __expf(bend);
    __syncthreads();
    bf16x8 A[2]; A[0] = FRAG(L_VT, 16 * w + fr, 0); A[1] = FRAG(L_VT, 16 * w + fr, 1);
    float* lt = P.LT + (size_t)u * 8192;
#pragma unroll
    for (int cb = 0; cb < 4; ++cb) { f32x4 acc = {0.f, 0.f, 0.f, 0.f};
#pragma unroll
        for (int ks = 0; ks < 2; ++ks) acc = mfma16(A[ks], FRAG(L_KET, 16 * cb + fr, ks), acc);
#pragma unroll
        for (int i = 0; i < 4; ++i) lt[(16 * w + 4 * fq + i) * 64 + 16 * cb + fr] = acc[i]; }
}
__device__ __forceinline__ void gla_scan(const Ptrs& P, int l, int G) {
    const int tid = fresh_tid();
    for (int p = (int)blockIdx.x * 512 + tid; p < 131072; p += G * 512) {
        const int kd = (p & 31) * 2, vd = (p >> 5) & 127, h = (p >> 12) & 15, b = p >> 16;
        float s0 = 0.f, s1 = 0.f;
        for (int n0 = 0; n0 < 64; n0 += 8) {
            f32x2 Lv[8], dv[8];
#pragma unroll
            for (int j = 0; j < 8; ++j) { const size_t u = (size_t)((b * 64 + n0 + j) * 16 + h); Lv[j] = *(const f32x2*)(P.LT + u * 8192 + vd * 64 + kd); dv[j] = *(const f32x2*)(P.DEC + u * 64 + kd); }
#pragma unroll
            for (int j = 0; j < 8; ++j) { const size_t u = (size_t)((b * 64 + n0 + j) * 16 + h); *(unsigned*)(P.SPT + u * 8192 + vd * 64 + kd) = pk2(s0, s1);
                s0 = dv[j].x * s0 + Lv[j].x; s1 = dv[j].y * s1 + Lv[j].y; }
        }
        float* o = P.out + O_GLAP + ((size_t)((l * 2 + b) * 16 + h) * 64 + kd) * 128 + vd;
        o[0] = s0; o[128] = s1;
    }
}
__device__ __forceinline__ void gla_out_unit(LAS unsigned char* lds, const Ptrs& P, int l, int row0, int ntok, int h, const bf16* spt, const float* sin, float* sout) {
    const int tid = fresh_tid(), lane = tid & 63, w = __builtin_amdgcn_readfirstlane(tid >> 6), fr = lane & 15, fq = lane >> 4, kd = tid & 63, oct = w;
    __syncthreads();
    gla_stage_alr(lds, P.ALR, row0, ntok, tid);
    gla_stage_vt(lds, P.HP, row0, ntok, h, tid);
    if (spt) {
#pragma unroll
        for (int q = 0; q < 2; ++q) { const int p = tid + 512 * q, vdp = p >> 3, c = p & 7; *(LAS v4u*)(lds + L_ST + vdp * 144 + c * 16) = *(const v4u*)(spt + vdp * 64 + c * 8); }
    } else {
        const int vd = tid & 127, tq = tid >> 7;
#pragma unroll
        for (int hf = 0; hf < 2; ++hf) { v4u o; const float* sp = sin + (size_t)(16 * tq + 8 * hf) * 128 + vd;
            o.x = pk2(sp[0], sp[128]); o.y = pk2(sp[256], sp[384]); o.z = pk2(sp[512], sp[640]); o.w = pk2(sp[768], sp[896]);
            *(LAS v4u*)(lds + L_ST + vd * 144 + tq * 32 + hf * 16) = o; }
    }
    __syncthreads();
    float bc[8], bend;
    gla_gates(lds, P.w_alpha2 + (size_t)l * 16 * 1024, P.b_alpha + l * 1024, h, ntok, kd, oct, bc, bend);
    { const bf16* qp = P.HP + (size_t)(row0 + 8 * oct) * NPROJ + C_Q + h * 64 + kd; const bf16* kp = qp + (C_K - C_Q); float ke[8];
#pragma unroll
      for (int i = 0; i < 8; ++i) { const int t = 8 * oct + i; const bool ok = t < ntok;
          const float qv = ok ? bf2f(qp[(size_t)i * NPROJ]) : 0.f, kv = ok ? bf2f(kp[(size_t)i * NPROJ]) : 0.f;
          *(LAS unsigned short*)(lds + L_QT + t * 144 + kd * 2) = (unsigned short)f2bf(qv * 0.125f * __expf(bc[i]));
          *(LAS unsigned short*)(lds + L_KT + t * 144 + kd * 2) = (unsigned short)f2bf(kv * __expf(-bc[i]));
          ke[i] = kv * __expf(bend - bc[i]); }
      if (sout) { v4u o; o.x = pk2(ke[0], ke[1]); o.y = pk2(ke[2], ke[3]); o.z = pk2(ke[4], ke[5]); o.w = pk2(ke[6], ke[7]); *(LAS v4u*)(lds + L_KET + kd * 144 + oct * 16) = o; } }
    if (oct == 0) ((LAS float*)(lds + L_DEC))[kd] = __expf(bend);
    __syncthreads();
    { const int rb = w >> 1; bf16x8 Aq[2]; Aq[0] = FRAG(L_QT, 16 * rb + fr, 0); Aq[1] = FRAG(L_QT, 16 * rb + fr, 1);
#pragma unroll
      for (int c2 = 0; c2 < 2; ++c2) { const int cb = 2 * (w & 1) + c2; f32x4 acc = {0.f, 0.f, 0.f, 0.f};
#pragma unroll
          for (int ks = 0; ks < 2; ++ks) acc = mfma16(Aq[ks], FRAG(L_KT, 16 * cb + fr, ks), acc);
#pragma unroll
          for (int ii = 0; ii < 4; ++ii) { const int i = 16 * rb + 4 * fq + ii, j = 16 * cb + fr; *(LAS unsigned short*)(lds + L_ATT + i * 144 + j * 2) = (unsigned short)f2bf(j <= i ? acc[ii] : 0.f); } } }
    __syncthreads();
    f32x4 o[4];
#pragma unroll
    for (int rb = 0; rb < 4; ++rb) o[rb] = (f32x4){0.f, 0.f, 0.f, 0.f};
#pragma unroll
    for (int ks = 0; ks < 2; ++ks) { const bf16x8 Bv = FRAG(L_VT, 16 * w + fr, ks);
#pragma unroll
        for (int rb = 0; rb < 4; ++rb) o[rb] = mfma16(FRAG(L_ATT, 16 * rb + fr, ks), Bv, o[rb]); }
#pragma unroll
    for (int ks = 0; ks < 2; ++ks) { const bf16x8 Bs = FRAG(L_ST, 16 * w + fr, ks);
#pragma unroll
        for (int rb = 0; rb < 4; ++rb) o[rb] = mfma16(FRAG(L_QT, 16 * rb + fr, ks), Bs, o[rb]); }
#pragma unroll
    for (int rb = 0; rb < 4; ++rb)
#pragma unroll
        for (int ii = 0; ii < 4; ++ii) { float s = o[rb][ii] * o[rb][ii]; s += __shfl_xor(s, 1); s += __shfl_xor(s, 2); s += __shfl_xor(s, 4); s += __shfl_xor(s, 8);
            if (fr == 0) ((LAS float*)(lds + L_SS))[w * 64 + 16 * rb + 4 * fq + ii] = s; }
    __syncthreads();
    if (tid < 64) { float s = 0.f;
#pragma unroll
        for (int ww = 0; ww < 8; ++ww) s += ((const LAS float*)(lds + L_SS))[ww * 64 + tid];
        ((LAS float*)(lds + L_RS))[tid] = rsqrtf(s * (1.f / 128.f) + EPS); }
    __syncthreads();
    { const int col = h * 128 + 16 * w + fr; const float gon = P.g_onorm[l * 128 + 16 * w + fr];
#pragma unroll
      for (int rb = 0; rb < 4; ++rb)
#pragma unroll
          for (int ii = 0; ii < 4; ++ii) { const int i = 16 * rb + 4 * fq + ii;
              if (i < ntok) { const float gv = bf2f(P.HP[(size_t)(row0 + i) * NPROJ + C_G + col]);
                  P.MIX[(size_t)(row0 + i) * D + col] = (bf16)f2bf(o[rb][ii] * ((const LAS float*)(lds + L_RS))[i] * gon * silu_f(gv)); } } }
    if (sout) {
        bf16x8 A[2]; A[0] = FRAG(L_VT, 16 * w + fr, 0); A[1] = FRAG(L_VT, 16 * w + fr, 1);
#pragma unroll
        for (int cb = 0; cb < 4; ++cb) { f32x4 acc = {0.f, 0.f, 0.f, 0.f};
#pragma unroll
            for (int ks = 0; ks < 2; ++ks) acc = mfma16(A[ks], FRAG(L_KET, 16 * cb + fr, ks), acc);
            const int kdx = 16 * cb + fr; const float dk = ((const LAS float*)(lds + L_DEC))[kdx];
#pragma unroll
            for (int ii = 0; ii < 4; ++ii) { const int vdx = 16 * w + 4 * fq + ii; sout[(size_t)kdx * 128 + vdx] = dk * sin[(size_t)kdx * 128 + vdx] + acc[ii]; } }
    }
}

__device__ __forceinline__ void lru_unit(LAS unsigned char* lds, const Ptrs& P, int l, int row0, int ntok, int hC, bool hasprev, const float* cbuf, int mode,
                                         float* asum, float* bsum, const float* hin, float* lru_out, float* conv_out) {
    const int tid = fresh_tid(), lane = tid & 63, w = __builtin_amdgcn_readfirstlane(tid >> 6), fr = lane & 15, fq = lane >> 4;
    const int c = tid & 127, tq = __builtin_amdgcn_readfirstlane(tid >> 7), cc = hC * 128 + c;
    __syncthreads();
    float xw[19];
#pragma unroll
    for (int k = 0; k < 19; ++k) { const int t = 16 * tq - 3 + k;
        if (t >= 0) xw[k] = (t < ntok) ? bf2f(P.HP[(size_t)(row0 + t) * NPROJ + C_XC + cc]) : 0.f;
        else xw[k] = hasprev ? bf2f(P.HP[(size_t)(row0 + t) * NPROJ + C_XC + cc]) : (cbuf ? cbuf[(3 + t) * 1024 + cc] : 0.f); }
    float xv[16];
    { const float* cw = P.conv_w + (size_t)l * 4 * 1024 + cc; const float w0 = cw[0], w1 = cw[1024], w2 = cw[2048], w3 = cw[3072], cb0 = P.conv_b[l * 1024 + cc];
#pragma unroll
      for (int i = 0; i < 16; ++i) { xv[i] = cb0 + w0 * xw[i] + w1 * xw[i + 1] + w2 * xw[i + 2] + w3 * xw[i + 3];
          *(LAS unsigned short*)(lds + L_XC + (16 * tq + i) * 272 + c * 2) = (unsigned short)f2bf(xv[i]); } }
    __syncthreads();
    {
        f32x4 ar[4], ag[4];
#pragma unroll
        for (int rb = 0; rb < 4; ++rb) { ar[rb] = (f32x4){0.f, 0.f, 0.f, 0.f}; ag[rb] = (f32x4){0.f, 0.f, 0.f, 0.f}; }
        const bf16* wr = P.WRT + ((size_t)(l * 8 + hC) * 128 + 16 * w + fr) * 128; const bf16* wi = P.WIT + ((size_t)(l * 8 + hC) * 128 + 16 * w + fr) * 128;
#pragma unroll
        for (int ks = 0; ks < 4; ++ks) { const bf16x8 Br = *(const bf16x8*)(wr + 32 * ks + 8 * fq), Bi = *(const bf16x8*)(wi + 32 * ks + 8 * fq);
#pragma unroll
            for (int rb = 0; rb < 4; ++rb) { const bf16x8 A = *(const LAS bf16x8*)(lds + L_XC + (16 * rb + fr) * 272 + (32 * ks + 8 * fq) * 2); ar[rb] = mfma16(A, Br, ar[rb]); ag[rb] = mfma16(A, Bi, ag[rb]); } }
        const int j = 16 * w + fr; const float brj = P.b_rgate[l * 1024 + hC * 128 + j], bij = P.b_igate[l * 1024 + hC * 128 + j];
#pragma unroll
        for (int rb = 0; rb < 4; ++rb)
#pragma unroll
            for (int ii = 0; ii < 4; ++ii) { const int t = 16 * rb + 4 * fq + ii; ((LAS float*)(lds + L_RG))[t * 132 + j] = sigmoid_f(ar[rb][ii] + brj); ((LAS float*)(lds + L_IG))[t * 132 + j] = sigmoid_f(ag[rb][ii] + bij); }
    }
    __syncthreads();
    const float sp = log1pf(expf(-P.lru_lambda[l * 1024 + cc]));
    float av[16], bv[16], Aq = 1.f, Bq = 0.f;
#pragma unroll
    for (int i = 0; i < 16; ++i) { const int t = 16 * tq + i; const float r = ((const LAS float*)(lds + L_RG))[t * 132 + c], ig = ((const LAS float*)(lds + L_IG))[t * 132 + c];
        const float la = -8.f * r * sp; float a = __expf(la), bt = sqrtf(-expm1f(2.f * la)) * (ig * xv[i]);
        if (t >= ntok) { a = 1.f; bt = 0.f; }
        av[i] = a; bv[i] = bt; Aq *= a; Bq = a * Bq + bt; }
    ((LAS float*)(lds + L_QA))[tq * 128 + c] = Aq; ((LAS float*)(lds + L_QB))[tq * 128 + c] = Bq;
    __syncthreads();
    if (mode == 0) {
        if (tq == 0) { float A = 1.f, B = 0.f;
#pragma unroll
            for (int q = 0; q < 4; ++q) { const float a = ((const LAS float*)(lds + L_QA))[q * 128 + c], b = ((const LAS float*)(lds + L_QB))[q * 128 + c]; A *= a; B = a * B + b; }
            asum[cc] = A; bsum[cc] = B; }
        return;
    }
    float hc = hin[cc];
#pragma unroll
    for (int q = 0; q < 3; ++q) if (q < tq) hc = ((const LAS float*)(lds + L_QA))[q * 128 + c] * hc + ((const LAS float*)(lds + L_QB))[q * 128 + c];
#pragma unroll
    for (int i = 0; i < 16; ++i) { hc = av[i] * hc + bv[i]; const int t = 16 * tq + i;
        if (t < ntok) { const float gv = bf2f(P.HP[(size_t)(row0 + t) * NPROJ + C_GC + cc]); P.MIX[(size_t)(row0 + t) * D + 3072 + cc] = (bf16)f2bf(hc * gelu_f(gv)); } }
    if (lru_out && tq == 3) lru_out[cc] = hc;
    if (conv_out && tq == ((ntok - 1) >> 4)) { conv_out[cc] = xw[16]; conv_out[1024 + cc] = xw[17]; conv_out[2048 + cc] = xw[18]; }
}
__device__ __forceinline__ void lru_carry(const Ptrs& P, int G) {
    const int tid = fresh_tid();
    if (tid < 8) {
        for (int p = (int)blockIdx.x * 8 + tid; p < 2048; p += G * 8) {
            const int b = p >> 10, cc = p & 1023; float hc = 0.f;
            for (int n0 = 0; n0 < 64; n0 += 8) { float a[8], bb[8];
#pragma unroll
                for (int j = 0; j < 8; ++j) { a[j] = P.LA[(size_t)(b * 64 + n0 + j) * 1024 + cc]; bb[j] = P.LB[(size_t)(b * 64 + n0 + j) * 1024 + cc]; }
#pragma unroll
                for (int j = 0; j < 8; ++j) { P.HIN[(size_t)(b * 64 + n0 + j) * 1024 + cc] = hc; hc = a[j] * hc + bb[j]; } }
        }
    }
}

__device__ __forceinline__ void gmlp_unit(LAS unsigned char* lds, const Ptrs& P, int l, int row0, int ntok, int hB, float* vout) {
    const int tid = fresh_tid(), lane = tid & 63, w = __builtin_amdgcn_readfirstlane(tid >> 6), fr = lane & 15, fq = lane >> 4;
    const int d = tid & 127, jq = __builtin_amdgcn_readfirstlane(tid >> 7);
    __syncthreads();
#pragma unroll
    for (int part = 0; part < 4; ++part) { v4u o; unsigned pk[4];
#pragma unroll
        for (int i2 = 0; i2 < 4; ++i2) { const int j0 = 32 * jq + 8 * part + 2 * i2; float v0 = 0.f, v1 = 0.f;
            if (j0 < ntok) { v0 = gelu_f(bf2f(P.HP[(size_t)(row0 + j0) * NPROJ + C_VB + hB * 128 + d])); v1 = gelu_f(bf2f(P.HP[(size_t)(row0 + j0 + 1) * NPROJ + C_VB + hB * 128 + d]));
                if (vout) { vout[(size_t)j0 * 1024 + hB * 128 + d] = v0; vout[(size_t)(j0 + 1) * 1024 + hB * 128 + d] = v1; } }
            pk[i2] = pk2(v0, v1); }
        o.x = pk[0]; o.y = pk[1]; o.z = pk[2]; o.w = pk[3];
        *(LAS v4u*)(lds + L_VT2 + d * 272 + jq * 64 + part * 16) = o; }
    __syncthreads();
    f32x4 acc[8];
#pragma unroll
    for (int rb = 0; rb < 8; ++rb) acc[rb] = (f32x4){0.f, 0.f, 0.f, 0.f};
    const bf16* wsp = P.WSP + (size_t)(l * 8 + hB) * 128 * 128;
#pragma unroll
    for (int ks = 0; ks < 4; ++ks) { const bf16x8 B = *(const LAS bf16x8*)(lds + L_VT2 + (16 * w + fr) * 272 + (32 * ks + 8 * fq) * 2);
#pragma unroll
        for (int rb = 0; rb < 8; ++rb) if (32 * ks <= 16 * rb + 15 && 16 * rb < ntok) { const bf16x8 A = *(const bf16x8*)(wsp + (16 * rb + fr) * 128 + 32 * ks + 8 * fq); acc[rb] = mfma16(A, B, acc[rb]); } }
    const int col = hB * 128 + 16 * w + fr;
#pragma unroll
    for (int rb = 0; rb < 8; ++rb) if (16 * rb < ntok) {
#pragma unroll
        for (int ii = 0; ii < 4; ++ii) { const int i = 16 * rb + 4 * fq + ii; const float mixed = acc[rb][ii] + P.b_spatial[(l * 8 + hB) * 128 + i];
            const float uv = gelu_f(bf2f(P.HP[(size_t)(row0 + i) * NPROJ + C_U + col])); P.MIX[(size_t)(row0 + i) * D + 2048 + col] = (bf16)f2bf(uv * mixed); } }
}


typedef const __attribute__((address_space(4))) Args* CArgsP;
__device__ __forceinline__ void load_ptrs(Ptrs& P) {
    CArgsP a = (CArgsP)__builtin_amdgcn_kernarg_segment_ptr();
    asm volatile("" : "+s"(a));
    unsigned char* ws = a->ws;
    P.x_prompt = a->in[0]; P.x_sample = a->in[1]; P.state_gla = a->in[2]; P.state_conv = a->in[3]; P.state_lru = a->in[4]; P.ln1 = a->in[5]; P.w_in = a->in[6]; P.w_alpha2 = a->in[7];
    P.b_alpha = a->in[8]; P.g_onorm = a->in[9]; P.w_spatial = a->in[10]; P.b_spatial = a->in[11]; P.conv_w = a->in[12]; P.conv_b = a->in[13]; P.w_rgate = a->in[14]; P.b_rgate = a->in[15];
    P.w_igate = a->in[16]; P.b_igate = a->in[17]; P.lru_lambda = a->in[18]; P.w_out = a->in[19]; P.ln2 = a->in[20]; P.w_up = a->in[21]; P.w_down = a->in[22]; P.ln_final = a->in[23];
    P.out = a->out;
    P.WIN = (bf16*)(ws + WS_WIN); P.WOUT = (bf16*)(ws + WS_WOUT); P.WUP = (bf16*)(ws + WS_WUP); P.WDN = (bf16*)(ws + WS_WDN); P.WA = (bf16*)(ws + WS_WA); P.WRT = (bf16*)(ws + WS_WRT); P.WIT = (bf16*)(ws + WS_WIT); P.WSP = (bf16*)(ws + WS_WSP);
    P.XN = (bf16*)(ws + WS_XN); P.HP = (bf16*)(ws + WS_HP); P.MIX = (bf16*)(ws + WS_MIX); P.HH = (bf16*)(ws + WS_HH); P.SPT = (bf16*)(ws + WS_SPT);
    P.X = (float*)(ws + WS_X); P.LT = (float*)(ws + WS_LT); P.DEC = (float*)(ws + WS_DEC); P.ALR = (float*)(ws + WS_ALR); P.LA = (float*)(ws + WS_LA); P.LB = (float*)(ws + WS_LB); P.HIN = (float*)(ws + WS_HIN);
}
__global__ void __launch_bounds__(512, 2) hybrid_fwd(Args args) {
    extern __shared__ __attribute__((aligned(16))) unsigned char lds_raw[];
    LAS unsigned char* lds = (LAS unsigned char*)lds_raw;
    const int tid = fresh_tid(), G = gridDim.x;
    for (int u = tid; u < (LDS_BYTES - LDSCTL_OFF) / 4; u += 512) ((LAS unsigned*)(lds + LDSCTL_OFF))[u] = 0u;
    __syncthreads();
    { CArgsP a0 = (CArgsP)__builtin_amdgcn_kernarg_segment_ptr(); (void)xcd_barrier_post((unsigned*)(a0->ws + WS_CTL) + CW_BAR, (volatile LAS unsigned*)(lds + MISC_OFF) + 8); }
#define GRID_BAR() do { CArgsP a1_ = (CArgsP)__builtin_amdgcn_kernarg_segment_ptr(); asm volatile("" : "+s"(a1_)); XcdBarrier b_; b_.bar = (unsigned*)(a1_->ws + WS_CTL) + CW_BAR; b_.x = xb_xcc_id(); \
        b_.st = (volatile LAS unsigned*)(lds + MISC_OFF) + 8; xcd_barrier(b_); } while (0)

#if PH_PRO
    { Ptrs P; load_ptrs(P); prologue(lds, P, G); }
#endif
    GRID_BAR();

    for (int l = 0; l < 2; ++l) {
#if PH_N1
        { Ptrs P; load_ptrs(P); const float* xa = (l == 0) ? P.x_prompt : P.X; const float* xb = (l == 0) ? P.x_sample : P.X + (size_t)MP * D;
          norm_phase<1>(lds, xa, xb, P.ln1 + l * D, P.XN, P.WA + (size_t)l * 16 * D, P.ALR, nullptr, nullptr, G); }
#endif
        GRID_BAR();
#if PH_GIN
        { Ptrs P; load_ptrs(P); pg8::Gemm g{P.XN, P.WIN + (size_t)l * NPROJ * D, MT, NPROJ, D}; pg8::StaticOrder S; S.init(MT, NPROJ, G, (int)blockIdx.x);
          pg8::EpiBf16<0> E{P.HP, NPROJ, nullptr, 0, 0, 1.f};
          pg8::gemm_phase<pg8::EpiBf16<0>, pg8::StaticOrder, true, true>(lds, g, S, E); }
#endif
        GRID_BAR();
#if PH_M1
        { Ptrs P; load_ptrs(P);
        for (int u = (int)blockIdx.x; u < 2048 + 1024; u += G) {
            if (u < 2048) gla_local_unit(lds, P, l, u);
            else { const int v = u - 2048, b = v >> 9, n = (v >> 3) & 63, hC = v & 7;
                lru_unit(lds, P, l, b * 4096 + n * 64, 64, hC, n > 0, nullptr, 0, P.LA + (size_t)(b * 64 + n) * 1024, P.LB + (size_t)(b * 64 + n) * 1024, nullptr, nullptr, nullptr); }
        } }
#endif
        GRID_BAR();
#if PH_M2A
        { Ptrs P; load_ptrs(P); gla_scan(P, l, G); }
#endif
#if PH_M2B
        { Ptrs P; load_ptrs(P); lru_carry(P, G); }
#endif
#if PH_M2C
        { Ptrs P; load_ptrs(P);
        for (int u = (int)blockIdx.x; u < 512 + 64; u += G) {
            if (u < 512) { const int b = u >> 8, n = (u >> 3) & 31, hB = u & 7; gmlp_unit(lds, P, l, b * 4096 + n * 128, 128, hB, nullptr); }
            else { const int v = u - 512, s = v >> 3, hB = v & 7; gmlp_unit(lds, P, l, MP + s * 32, 32, hB, P.out + O_VS + (size_t)(l * 8 + s) * 32 * 1024); }
        } }
#endif
        GRID_BAR();
#if PH_M3
        { Ptrs P; load_ptrs(P);
        for (int u = (int)blockIdx.x; u < 2048 + 128 + 1024 + 64; u += G) {
            if (u < 2048) { const int b = u >> 10, n = (u >> 4) & 63, h = u & 15; gla_out_unit(lds, P, l, b * 4096 + n * 64, 64, h, P.SPT + (size_t)u * 8192, nullptr, nullptr); }
            else if (u < 2176) { const int v = u - 2048, s = v >> 4, h = v & 15; const size_t so = (size_t)((l * 8 + s) * 16 + h) * 8192;
                gla_out_unit(lds, P, l, MP + s * 32, 32, h, nullptr, P.state_gla + so, P.out + O_GLAS + so); }
            else if (u < 3200) { const int v = u - 2176, b = v >> 9, n = (v >> 3) & 63, hC = v & 7; const bool lastc = (n == 63);
                lru_unit(lds, P, l, b * 4096 + n * 64, 64, hC, n > 0, nullptr, 1, nullptr, nullptr, P.HIN + (size_t)(b * 64 + n) * 1024,
                         lastc ? P.out + O_LRUP + (size_t)(l * 2 + b) * 1024 : nullptr, lastc ? P.out + O_CONVP + (size_t)(l * 2 + b) * 3 * 1024 : nullptr); }
            else { const int v = u - 3200, s = v >> 3, hC = v & 7;
                lru_unit(lds, P, l, MP + s * 32, 32, hC, false, P.state_conv + (size_t)(l * 8 + s) * 3 * 1024, 1, nullptr, nullptr, P.state_lru + (size_t)(l * 8 + s) * 1024,
                         P.out + O_LRUS + (size_t)(l * 8 + s) * 1024, P.out + O_CONVS + (size_t)(l * 8 + s) * 3 * 1024); }
        } }
#endif
        GRID_BAR();
#if PH_GOUT
        { Ptrs P; load_ptrs(P); const float* xa = (l == 0) ? P.x_prompt : P.X; const float* xb = (l == 0) ? P.x_sample : P.X + (size_t)MP * D;
          pg8::Gemm g{P.MIX, P.WOUT + (size_t)l * D * D, MT, D, D}; pg8::StaticOrder S; S.init(MT, D, G, (int)blockIdx.x);
          pg8::EpiResid E{xa, xb, P.X, D};
          pg8::gemm_phase<pg8::EpiResid, pg8::StaticOrder, true, true>(lds, g, S, E); }
#endif
        GRID_BAR();
#if PH_N2
        { Ptrs P; load_ptrs(P); norm_phase<0>(lds, P.X, P.X + (size_t)MP * D, P.ln2 + l * D, P.XN, nullptr, nullptr, nullptr, nullptr, G); }
#endif
        GRID_BAR();
#if PH_GUP
        { Ptrs P; load_ptrs(P); pg8::Gemm g{P.XN, P.WUP + (size_t)l * DFF * D, MT, DFF, D}; pg8::StaticOrder S; S.init(MT, DFF, G, (int)blockIdx.x);
          pg8::EpiRelu2 E{P.HH, DFF};
          pg8::gemm_phase<pg8::EpiRelu2, pg8::StaticOrder, true, true>(lds, g, S, E); }
#endif
        GRID_BAR();
#if PH_GDN
        { Ptrs P; load_ptrs(P); pg8::Gemm g{P.HH, P.WDN + (size_t)l * D * DFF, MT, D, DFF}; pg8::StaticOrder S; S.init(MT, D, G, (int)blockIdx.x);
          pg8::EpiResid E{P.X, P.X + (size_t)MP * D, P.X, D};
          pg8::gemm_phase<pg8::EpiResid, pg8::StaticOrder, true, true>(lds, g, S, E); }
#endif
        GRID_BAR();
    }
#if PH_NF
    { Ptrs P; load_ptrs(P); norm_phase<2>(lds, P.X, P.X + (size_t)MP * D, P.ln_final, nullptr, nullptr, nullptr, P.out + O_YP, P.out + O_YS, G); }
#endif
}

extern "C" void kernel_launch(void* const* d_in, const int* in_sizes, int n_in, void* d_out, int out_size, void* d_ws, size_t ws_size, hipStream_t stream) {
    static int grid = 0;
    if (grid == 0) {
        if (n_in != 24 || (size_t)out_size != O_END || ws_size < WS_END) { fprintf(stderr, "kernel_launch: unexpected shapes (n_in %d, out %d, ws %zu); nothing launched\n", n_in, out_size, ws_size); grid = -1; return; }
        int dev = 0, cus = 0;
        if (hipGetDevice(&dev) != hipSuccess || hipDeviceGetAttribute(&cus, hipDeviceAttributeMultiprocessorCount, dev) != hipSuccess) { grid = -1; return; }
        if (hipFuncSetAttribute((const void*)hybrid_fwd, hipFuncAttributeMaxDynamicSharedMemorySize, LDS_BYTES) != hipSuccess) { fprintf(stderr, "kernel_launch: hipFuncSetAttribute failed\n"); grid = -1; return; }
        int per_cu = 0;
        if (hipOccupancyMaxActiveBlocksPerMultiprocessor(&per_cu, (const void*)hybrid_fwd, 512, LDS_BYTES) != hipSuccess || per_cu < 1) fprintf(stderr, "kernel_launch: occupancy query reports %d workgroups per CU\n", per_cu);
        (void)hipGetLastError();
        grid = cus;
    }
    if (grid < 0) return;
    if (hipMemsetAsync((char*)d_ws + WS_CTL, 0, CTL_ZERO_BYTES, stream) != hipSuccess) return;
    Args a{};
    for (int i = 0; i < 24; ++i) a.in[i] = (const float*)d_in[i];
    a.out = (float*)d_out; a.ws = (unsigned char*)d_ws;
    hipLaunchKernelGGL(hybrid_fwd, dim3(grid), dim3(512), LDS_BYTES, stream, a);
}
```
